# Optimizing an MI355X kernel written in HIP

```python
import jax, jax.numpy as jnp
from jax import lax
import numpy as np

D_MODEL = 1024
BATCH = 4
SEQ = 8192
DEPTH = 1
DEC_BATCH = 128
DEC_SEQ = 4
PAST_LEN = 16384
PAGE_SIZE = 128

HEAD_DIM = 64
N_HEADS = D_MODEL // HEAD_DIM
N_CHUNK_HEADS = N_HEADS // 2
N_ATTN_HEADS = N_HEADS - N_CHUNK_HEADS
N_KV_HEADS = 2
Q_PER_KV = N_ATTN_HEADS // N_KV_HEADS
CHUNK_WIDTH = N_CHUNK_HEADS * HEAD_DIM
ATTN_WIDTH = N_ATTN_HEADS * HEAD_DIM
KV_WIDTH = N_KV_HEADS * HEAD_DIM
IN_WIDTH = 2 * CHUNK_WIDTH + ATTN_WIDTH + 2 * KV_WIDTH
SPLITS = (CHUNK_WIDTH, 2 * CHUNK_WIDTH, 2 * CHUNK_WIDTH + ATTN_WIDTH, 2 * CHUNK_WIDTH + ATTN_WIDTH + KV_WIDTH)
CHUNK = 128
WINDOW = 128
D_FF = 4 * D_MODEL
EPS = 1e-6
ATTN_SCALE = HEAD_DIM ** -0.5

kernel_name = 'hymba_chunkmlp_swa_sink_step'


def rms_norm(x, g):
    xf = x.astype(jnp.float32)
    y = xf * lax.rsqrt(jnp.mean(xf * xf, axis=-1, keepdims=True) + EPS)
    return (y * g.astype(jnp.float32)).astype(x.dtype)


def layer_norm(x, g, b):
    xf = x.astype(jnp.float32)
    xc = xf - jnp.mean(xf, axis=-1, keepdims=True)
    y = xc * lax.rsqrt(jnp.mean(xc * xc, axis=-1, keepdims=True) + EPS)
    return (y * g.astype(jnp.float32) + b.astype(jnp.float32)).astype(x.dtype)


def alibi_slopes():
    i = jnp.arange(1, N_ATTN_HEADS + 1, dtype=jnp.float32)
    return jnp.exp2(-8.0 * i / N_ATTN_HEADS).reshape(N_KV_HEADS, Q_PER_KV)


def mixer_projections(x, g_pre, w_in, ln_g, ln_b):
    h = rms_norm(x, g_pre)
    z = jnp.einsum('bsd,de->bse', h, w_in)
    u, v, q, k, val = jnp.split(z, SPLITS, axis=-1)
    u = jax.nn.gelu(u)
    v = layer_norm(jax.nn.gelu(v), ln_g, ln_b)
    return u, v, q, k, val


def spatial_gate(u, v, w_s, b_s):
    B, C, n, _ = v.shape
    causal = jnp.tril(jnp.ones((n, n), dtype=bool))
    w = jnp.where(causal, w_s[:, :n, :n], 0).astype(v.dtype)
    vh = v.reshape(B, C, n, N_CHUNK_HEADS, HEAD_DIM)
    s = jnp.einsum('gts,bcsgd->bctgd', w, vh) + b_s[:, :n].T[:, :, None].astype(v.dtype)
    return u * s.reshape(B, C, n, CHUNK_WIDTH)


def sink_attention(q, k, v, dist, valid, sinks):
    s = jnp.einsum('...qhrd,...khd->...hrqk', q, k, preferred_element_type=jnp.float32) * ATTN_SCALE
    s = s - alibi_slopes()[:, :, None, None] * dist.astype(jnp.float32)
    s = jnp.where(valid, s, -jnp.inf)
    sink = sinks.astype(jnp.float32)[:, :, None, None]
    m = jnp.maximum(jnp.max(s, axis=-1, keepdims=True), sink)
    p = jnp.exp(s - m)
    z = jnp.sum(p, axis=-1, keepdims=True) + jnp.exp(sink - m)
    p = (p / z).astype(v.dtype)
    return jnp.einsum('...hrqk,...khd->...qhrd', p, v)


def swa_prompt(q, k, v, sinks):
    B, S, _ = q.shape
    nb = S // WINDOW
    qb = q.reshape(B, nb, WINDOW, N_KV_HEADS, Q_PER_KV, HEAD_DIM)

    def band(t):
        t = t.reshape(B, S, N_KV_HEADS, HEAD_DIM)
        t = jnp.pad(t, ((0, 0), (WINDOW, 0), (0, 0), (0, 0)))
        t = t.reshape(B, nb + 1, WINDOW, N_KV_HEADS, HEAD_DIM)
        return jnp.concatenate([t[:, :-1], t[:, 1:]], axis=2)

    kb, vb = band(k), band(v)
    a = jnp.arange(WINDOW)[:, None]
    c = jnp.arange(2 * WINDOW)[None, :]
    dist = WINDOW + a - c
    kpos = (jnp.arange(nb)[:, None, None] - 1) * WINDOW + c[None]
    valid = (dist >= 0) & (dist <= WINDOW) & (kpos >= 0)
    out = sink_attention(qb, kb, vb, dist, valid[:, None, None], sinks)
    return out.reshape(B, S, ATTN_WIDTH)


def swa_sample(q, k, v, cache_k, cache_v, sinks):
    Bd, L, _ = q.shape
    Wc = cache_k.shape[1]
    qh = q.reshape(Bd, L, N_KV_HEADS, Q_PER_KV, HEAD_DIM)
    kc = jnp.concatenate([cache_k, k.reshape(Bd, L, N_KV_HEADS, HEAD_DIM)], axis=1)
    vc = jnp.concatenate([cache_v, v.reshape(Bd, L, N_KV_HEADS, HEAD_DIM)], axis=1)
    dist = (Wc + jnp.arange(L)[:, None]) - jnp.arange(Wc + L)[None, :]
    valid = (dist >= 0) & (dist <= WINDOW)
    out = sink_attention(qh, kc, vc, dist, valid, sinks)
    return out.reshape(Bd, L, ATTN_WIDTH), kc[:, L:], vc[:, L:]


def merge_and_channel_mix(x, a_out, b_out, g_out_chunk, g_out_attn, w_o, g_post_mix,
                          g_pre_ffn, w_up, w_down, g_post_ffn):
    merged = jnp.concatenate([rms_norm(a_out, g_out_chunk), rms_norm(b_out, g_out_attn)], axis=-1)
    o = jnp.einsum('bsc,cd->bsd', merged, w_o)
    x = x + rms_norm(o, g_post_mix)
    h = rms_norm(x, g_pre_ffn)
    f = jnp.einsum('bsf,fd->bsd', jnp.square(jax.nn.relu(jnp.einsum('bsd,df->bsf', h, w_up))), w_down)
    return x + rms_norm(f, g_post_ffn)


def setup_inputs(seed: int = 0) -> dict:
    key = jax.random.key(seed)
    ks = jax.random.split(key, 20)
    f32 = jnp.float32
    win = min(WINDOW, PAST_LEN)
    nrm = lambda k, shape: jax.random.normal(k, shape, f32)
    return {
        'x_prompt': nrm(ks[0], (BATCH, SEQ, D_MODEL)),
        'x_sample': nrm(ks[1], (DEC_BATCH, DEC_SEQ, D_MODEL)),
        'cache_win_k': nrm(ks[2], (DEPTH, DEC_BATCH, win, N_KV_HEADS, HEAD_DIM)),
        'cache_win_v': nrm(ks[3], (DEPTH, DEC_BATCH, win, N_KV_HEADS, HEAD_DIM)),
        'w_in': nrm(ks[4], (DEPTH, D_MODEL, IN_WIDTH)) * D_MODEL ** -0.5,
        'g_pre_mix': 1.0 + 0.05 * nrm(ks[5], (DEPTH, D_MODEL)),
        'ln_v_g': 1.0 + 0.05 * nrm(ks[6], (DEPTH, CHUNK_WIDTH)),
        'ln_v_b': 0.02 * nrm(ks[7], (DEPTH, CHUNK_WIDTH)),
        'w_spatial': nrm(ks[8], (DEPTH, N_CHUNK_HEADS, CHUNK, CHUNK)) * 0.5 * CHUNK ** -0.5,
        'b_spatial': 1.0 + 0.1 * nrm(ks[9], (DEPTH, N_CHUNK_HEADS, CHUNK)),
        'attn_sinks': 0.5 * nrm(ks[10], (DEPTH, N_KV_HEADS, Q_PER_KV)),
        'g_out_chunk': 1.0 + 0.05 * nrm(ks[11], (DEPTH, CHUNK_WIDTH)),
        'g_out_attn': 1.0 + 0.05 * nrm(ks[12], (DEPTH, ATTN_WIDTH)),
        'w_o': nrm(ks[13], (DEPTH, CHUNK_WIDTH + ATTN_WIDTH, D_MODEL)) * (CHUNK_WIDTH + ATTN_WIDTH) ** -0.5,
        'g_post_mix': 1.0 + 0.05 * nrm(ks[14], (DEPTH, D_MODEL)),
        'g_pre_ffn': 1.0 + 0.05 * nrm(ks[15], (DEPTH, D_MODEL)),
        'w_up': nrm(ks[16], (DEPTH, D_MODEL, D_FF)) * D_MODEL ** -0.5,
        'w_down': nrm(ks[17], (DEPTH, D_FF, D_MODEL)) * D_FF ** -0.5,
        'g_post_ffn': 1.0 + 0.05 * nrm(ks[18], (DEPTH, D_MODEL)),
    }


def reference(x_prompt, x_sample, cache_win_k, cache_win_v, w_in, g_pre_mix, ln_v_g, ln_v_b,
              w_spatial, b_spatial, attn_sinks, g_out_chunk, g_out_attn, w_o, g_post_mix,
              g_pre_ffn, w_up, w_down, g_post_ffn):
    yp, ys = x_prompt, x_sample
    B, S, _ = x_prompt.shape
    Bd, L, _ = x_sample.shape
    wk_p, wv_p, cv_p, wk_s, wv_s, cv_s = [], [], [], [], [], []
    for l in range(DEPTH):
        u, v, q, k, val = mixer_projections(yp, g_pre_mix[l], w_in[l], ln_v_g[l], ln_v_b[l])
        a_out = spatial_gate(u.reshape(B, S // CHUNK, CHUNK, CHUNK_WIDTH),
                             v.reshape(B, S // CHUNK, CHUNK, CHUNK_WIDTH),
                             w_spatial[l], b_spatial[l]).reshape(B, S, CHUNK_WIDTH)
        b_out = swa_prompt(q, k, val, attn_sinks[l])
        yp = merge_and_channel_mix(yp, a_out, b_out, g_out_chunk[l], g_out_attn[l], w_o[l],
                                   g_post_mix[l], g_pre_ffn[l], w_up[l], w_down[l], g_post_ffn[l])
        wk_p.append(k.reshape(B, S, N_KV_HEADS, HEAD_DIM)[:, S - WINDOW:])
        wv_p.append(val.reshape(B, S, N_KV_HEADS, HEAD_DIM)[:, S - WINDOW:])
        cv_p.append(v[:, S - CHUNK:])

        u, v, q, k, val = mixer_projections(ys, g_pre_mix[l], w_in[l], ln_v_g[l], ln_v_b[l])
        a_out = spatial_gate(u[:, None], v[:, None], w_spatial[l], b_spatial[l])[:, 0]
        b_out, new_k, new_v = swa_sample(q, k, val, cache_win_k[l], cache_win_v[l], attn_sinks[l])
        ys = merge_and_channel_mix(ys, a_out, b_out, g_out_chunk[l], g_out_attn[l], w_o[l],
                                   g_post_mix[l], g_pre_ffn[l], w_up[l], w_down[l], g_post_ffn[l])
        wk_s.append(new_k)
        wv_s.append(new_v)
        cv_s.append(v)
    return (yp, ys, jnp.stack(wk_p), jnp.stack(wv_p), jnp.stack(cv_p),
            jnp.stack(wk_s), jnp.stack(wv_s), jnp.stack(cv_s))
```

```cpp
#include <hip/hip_runtime.h>
#include <cstdio>
#include <cstdint>

namespace {
constexpr int D = 1024, MP = 32768, MS = 512, M = MP + MS, SEQ = 8192, NB = 4, DB = 128, DL = 4;
constexpr int INW = 1792, CW = 512, FF = 4096;
constexpr float EPS = 1e-6f;

__device__ __forceinline__ float wave_sum(float v) {
#pragma unroll
    for (int o = 1; o < 64; o <<= 1) v += __shfl_xor(v, o);
    return v;
}
__device__ __forceinline__ float wave_max(float v) {
#pragma unroll
    for (int o = 1; o < 64; o <<= 1) v = fmaxf(v, __shfl_xor(v, o));
    return v;
}
__device__ __forceinline__ float gelu_tanh(float x) {
    return 0.5f * x * (1.f + tanhf(0.7978845608028654f * (x + 0.044715f * x * x * x)));
}

__global__ void k_rms_in(const float* xp, const float* xs, const float* g, float* out) {
    const int m = blockIdx.x * 4 + (threadIdx.x >> 6), lane = threadIdx.x & 63;
    const float* x = m < MP ? xp + (size_t)m * D : xs + (size_t)(m - MP) * D;
    float v[16]; float s = 0.f;
#pragma unroll
    for (int j = 0; j < 16; ++j) { v[j] = x[lane + 64 * j]; s += v[j] * v[j]; }
    const float r = rsqrtf(wave_sum(s) * (1.f / D) + EPS);
#pragma unroll
    for (int j = 0; j < 16; ++j) out[(size_t)m * D + lane + 64 * j] = v[j] * r * g[lane + 64 * j];
}

template <int EPI>
__global__ void __launch_bounds__(256) k_sgemm(const float* A, const float* B, float* C, int Mr, int N, int K) {
    __shared__ float sA[16][64 + 4];
    __shared__ float sB[16][64 + 4];
    const int tid = threadIdx.x, tx = tid & 15, ty = tid >> 4;
    const int m0 = blockIdx.y * 64, n0 = blockIdx.x * 64;
    float acc[4][4] = {};
    for (int k0 = 0; k0 < K; k0 += 16) {
        {
            const int r = tid >> 2, c4 = (tid & 3) * 4;
            const float4 a = *(const float4*)(A + (size_t)(m0 + r) * K + k0 + c4);
            sA[c4 + 0][r] = a.x; sA[c4 + 1][r] = a.y; sA[c4 + 2][r] = a.z; sA[c4 + 3][r] = a.w;
            const int kr = tid >> 4, c = (tid & 15) * 4;
            const float4 b = *(const float4*)(B + (size_t)(k0 + kr) * N + n0 + c);
            sB[kr][c] = b.x; sB[kr][c + 1] = b.y; sB[kr][c + 2] = b.z; sB[kr][c + 3] = b.w;
        }
        __syncthreads();
#pragma unroll
        for (int kk = 0; kk < 16; ++kk) {
            float a[4], b[4];
#pragma unroll
            for (int i = 0; i < 4; ++i) { a[i] = sA[kk][ty * 4 + i]; b[i] = sB[kk][tx * 4 + i]; }
#pragma unroll
            for (int i = 0; i < 4; ++i)
#pragma unroll
                for (int j = 0; j < 4; ++j) acc[i][j] += a[i] * b[j];
        }
        __syncthreads();
    }
#pragma unroll
    for (int i = 0; i < 4; ++i) {
        float4 o;
        float* p = &o.x;
#pragma unroll
        for (int j = 0; j < 4; ++j) { float v = acc[i][j]; if (EPI == 1) { v = fmaxf(v, 0.f); v = v * v; } p[j] = v; }
        *(float4*)(C + (size_t)(m0 + ty * 4 + i) * N + n0 + tx * 4) = o;
    }
}

__global__ void k_act(float* Z, const float* lng, const float* lnb, float* cvp, float* cvs) {
    const int m = blockIdx.x * 4 + (threadIdx.x >> 6), lane = threadIdx.x & 63;
    float* z = Z + (size_t)m * INW;
#pragma unroll
    for (int j = 0; j < 8; ++j) z[lane + 64 * j] = gelu_tanh(z[lane + 64 * j]);
    float v[8]; float s = 0.f;
#pragma unroll
    for (int j = 0; j < 8; ++j) { v[j] = gelu_tanh(z[512 + lane + 64 * j]); s += v[j]; }
    const float mean = wave_sum(s) * (1.f / CW);
    float q = 0.f;
#pragma unroll
    for (int j = 0; j < 8; ++j) { v[j] -= mean; q += v[j] * v[j]; }
    const float r = rsqrtf(wave_sum(q) * (1.f / CW) + EPS);
    float* cv = nullptr;
    if (m >= MP) cv = cvs + (size_t)(m - MP) * CW;
    else { const int b = m / SEQ, t = m % SEQ; if (t >= SEQ - 128) cv = cvp + (size_t)(b * 128 + t - (SEQ - 128)) * CW; }
#pragma unroll
    for (int j = 0; j < 8; ++j) {
        const int c = lane + 64 * j; const float o = v[j] * r * lng[c] + lnb[c];
        z[512 + c] = o; if (cv) cv[c] = o;
    }
}

__global__ void k_win(const float* Z, const float* ck, const float* cvv, float* wkp, float* wvp, float* wks, float* wvs) {
    const int i = blockIdx.x * 256 + threadIdx.x;
    if (i < NB * 128 * 128) {
        const int c = i & 127, j = (i >> 7) & 127, b = i >> 14;
        const float* z = Z + (size_t)(b * SEQ + SEQ - 128 + j) * INW;
        wkp[i] = z[1536 + c]; wvp[i] = z[1664 + c];
    } else {
        const int ii = i - NB * 128 * 128; if (ii >= DB * 128 * 128) return;
        const int c = ii & 127, j = (ii >> 7) & 127, bd = ii >> 14;
        if (j < 124) { wks[ii] = ck[(size_t)(bd * 128 + j + 4) * 128 + c]; wvs[ii] = cvv[(size_t)(bd * 128 + j + 4) * 128 + c]; }
        else { const float* z = Z + (size_t)(MP + bd * 4 + (j - 124)) * INW; wks[ii] = z[1536 + c]; wvs[ii] = z[1664 + c]; }
    }
}

__global__ void k_spatial(const float* Z, const float* ws, const float* bs, float* AB) {
    const int m = blockIdx.x >> 1, ch = (blockIdx.x & 1) * 256 + threadIdx.x, g = ch >> 6;
    int t, row0;
    if (m < MP) { t = m & 127; row0 = m - t; } else { t = (m - MP) & 3; row0 = m - t; }
    const float* w = ws + ((size_t)g * 128 + t) * 128;
    float s = 0.f;
    for (int sidx = 0; sidx <= t; ++sidx) s += w[sidx] * Z[(size_t)(row0 + sidx) * INW + 512 + ch];
    s += bs[g * 128 + t];
    AB[(size_t)m * D + ch] = Z[(size_t)m * INW + ch] * s;
}

__global__ void k_attn(const float* Z, const float* ck, const float* cvv, const float* sinks, float* AB) {
    __shared__ float sp[192];
    const int m = blockIdx.x >> 3, hq = blockIdx.x & 7, kvh = hq >> 2, lane = threadIdx.x;
    const float slope = exp2f(-(float)(hq + 1)), sink = sinks[hq];
    const float qv = Z[(size_t)m * INW + 1024 + hq * 64 + lane];
    float sc[3];
#pragma unroll
    for (int jj = 0; jj < 3; ++jj) {
        const int j = lane + 64 * jj;
        const float* kp = Z; bool valid = false;
        if (j <= 128) {
            if (m < MP) { const int t = m % SEQ; if (t - j >= 0) { kp = Z + (size_t)(m - j) * INW + 1536 + kvh * 64; valid = true; } }
            else { const int bd = (m - MP) >> 2, l = (m - MP) & 3, c = 128 + l - j; valid = true;
                   kp = c < 128 ? ck + ((size_t)(bd * 128 + c) * 2 + kvh) * 64 : Z + (size_t)(MP + bd * 4 + (c - 128)) * INW + 1536 + kvh * 64; }
        }
        float dsum = 0.f;
        for (int d = 0; d < 64; ++d) { const float qd = __shfl(qv, d); dsum += qd * kp[d]; }
        sc[jj] = valid ? dsum * 0.125f - slope * (float)j : -INFINITY;
    }
    float mx = wave_max(fmaxf(fmaxf(sc[0], sc[1]), sc[2])); mx = fmaxf(mx, sink);
    float psum = 0.f;
#pragma unroll
    for (int jj = 0; jj < 3; ++jj) { const float p = sc[jj] == -INFINITY ? 0.f : expf(sc[jj] - mx); sp[lane + 64 * jj] = p; psum += p; }
    const float zsum = wave_sum(psum) + expf(sink - mx);
    __syncthreads();
    float o = 0.f;
    for (int j = 0; j <= 128; ++j) {
        const float p = sp[j]; if (p == 0.f) continue;
        const float* vp;
        if (m < MP) vp = Z + (size_t)(m - j) * INW + 1664 + kvh * 64;
        else { const int bd = (m - MP) >> 2, l = (m - MP) & 3, c = 128 + l - j;
               vp = c < 128 ? cvv + ((size_t)(bd * 128 + c) * 2 + kvh) * 64 : Z + (size_t)(MP + bd * 4 + (c - 128)) * INW + 1664 + kvh * 64; }
        o += p * vp[lane];
    }
    AB[(size_t)m * D + 512 + hq * 64 + lane] = o / zsum;
}

__global__ void k_merge(float* AB, const float* gc, const float* ga) {
    const int m = blockIdx.x * 4 + (threadIdx.x >> 6), lane = threadIdx.x & 63;
    float* r = AB + (size_t)m * D;
#pragma unroll
    for (int h = 0; h < 2; ++h) {
        float v[8]; float s = 0.f;
#pragma unroll
        for (int j = 0; j < 8; ++j) { v[j] = r[h * 512 + lane + 64 * j]; s += v[j] * v[j]; }
        const float rr = rsqrtf(wave_sum(s) * (1.f / CW) + EPS);
        const float* g = h ? ga : gc;
#pragma unroll
        for (int j = 0; j < 8; ++j) r[h * 512 + lane + 64 * j] = v[j] * rr * g[lane + 64 * j];
    }
}

__global__ void k_res1(const float* xp, const float* xs, const float* O, const float* g1, const float* g2, float* out, float* XN2) {
    const int m = blockIdx.x * 4 + (threadIdx.x >> 6), lane = threadIdx.x & 63;
    const float* x = m < MP ? xp + (size_t)m * D : xs + (size_t)(m - MP) * D;
    float o[16], x1[16]; float s = 0.f;
#pragma unroll
    for (int j = 0; j < 16; ++j) { o[j] = O[(size_t)m * D + lane + 64 * j]; s += o[j] * o[j]; }
    const float r = rsqrtf(wave_sum(s) * (1.f / D) + EPS);
    float s2 = 0.f;
#pragma unroll
    for (int j = 0; j < 16; ++j) { const int c = lane + 64 * j; x1[j] = x[c] + o[j] * r * g1[c]; s2 += x1[j] * x1[j]; out[(size_t)m * D + c] = x1[j]; }
    const float r2 = rsqrtf(wave_sum(s2) * (1.f / D) + EPS);
#pragma unroll
    for (int j = 0; j < 16; ++j) { const int c = lane + 64 * j; XN2[(size_t)m * D + c] = x1[j] * r2 * g2[c]; }
}

__global__ void k_res2(const float* F, const float* g, float* out, int m0) {
    const int mm = blockIdx.x * 4 + (threadIdx.x >> 6), lane = threadIdx.x & 63, m = m0 + mm;
    float f[16]; float s = 0.f;
#pragma unroll
    for (int j = 0; j < 16; ++j) { f[j] = F[(size_t)mm * D + lane + 64 * j]; s += f[j] * f[j]; }
    const float r = rsqrtf(wave_sum(s) * (1.f / D) + EPS);
#pragma unroll
    for (int j = 0; j < 16; ++j) { const int c = lane + 64 * j; out[(size_t)m * D + c] += f[j] * r * g[c]; }
}
}

extern "C" void kernel_launch(void* const* d_in, const int* in_sizes, int n_in, void* d_out, int out_size, void* d_ws, size_t ws_size, hipStream_t stream) {
    const float* xp = (const float*)d_in[0]; const float* xs = (const float*)d_in[1];
    const float* ck = (const float*)d_in[2]; const float* cv = (const float*)d_in[3];
    const float* w_in = (const float*)d_in[4]; const float* g_pre = (const float*)d_in[5];
    const float* lng = (const float*)d_in[6]; const float* lnb = (const float*)d_in[7];
    const float* wsp = (const float*)d_in[8]; const float* bsp = (const float*)d_in[9];
    const float* sinks = (const float*)d_in[10]; const float* goc = (const float*)d_in[11]; const float* goa = (const float*)d_in[12];
    const float* w_o = (const float*)d_in[13]; const float* gpm = (const float*)d_in[14]; const float* gpf = (const float*)d_in[15];
    const float* w_up = (const float*)d_in[16]; const float* w_dn = (const float*)d_in[17]; const float* gpo = (const float*)d_in[18];
    float* out = (float*)d_out;
    float* y = out;
    float* wkp = out + (size_t)M * D; float* wvp = wkp + 65536; float* cvp = wvp + 65536;
    float* wks = cvp + 262144; float* wvs = wks + 2097152; float* cvs = wvs + 2097152;
    const size_t MiB = 1u << 20;
    char* ws = (char*)d_ws;
    float* XN = (float*)(ws);
    float* Z = (float*)(ws + 130 * MiB);
    float* AB = (float*)(ws + 358 * MiB);
    float* O = (float*)(ws);
    float* XN2 = (float*)(ws + 130 * MiB);
    float* H = (float*)(ws + 260 * MiB);
    float* F = (float*)(ws);
    if (ws_size < 490 * MiB) { fprintf(stderr, "ws too small\n"); return; }

    k_rms_in<<<M / 4, 256, 0, stream>>>(xp, xs, g_pre, XN);
    k_sgemm<0><<<dim3(INW / 64, M / 64), 256, 0, stream>>>(XN, w_in, Z, M, INW, D);
    k_act<<<M / 4, 256, 0, stream>>>(Z, lng, lnb, cvp, cvs);
    k_win<<<(NB * 128 * 128 + DB * 128 * 128) / 256, 256, 0, stream>>>(Z, ck, cv, wkp, wvp, wks, wvs);
    k_spatial<<<M * 2, 256, 0, stream>>>(Z, wsp, bsp, AB);
    k_attn<<<M * 8, 64, 0, stream>>>(Z, ck, cv, sinks, AB);
    k_merge<<<M / 4, 256, 0, stream>>>(AB, goc, goa);
    k_sgemm<0><<<dim3(D / 64, M / 64), 256, 0, stream>>>(AB, w_o, O, M, D, D);
    k_res1<<<M / 4, 256, 0, stream>>>(xp, xs, O, gpm, gpf, y, XN2);
    for (int c = 0; c < 4; ++c) {
        const int m0 = c * 8320;
        k_sgemm<1><<<dim3(FF / 64, 8320 / 64), 256, 0, stream>>>(XN2 + (size_t)m0 * D, w_up, H, 8320, FF, D);
        k_sgemm<0><<<dim3(D / 64, 8320 / 64), 256, 0, stream>>>(H, w_dn, F, 8320, D, FF);
        k_res2<<<8320 / 4, 256, 0, stream>>>(F, gpo, y, m0);
    }
}
```

```cpp
#include <hip/hip_runtime.h>
#include <cstdio>
#include <cstdint>
namespace pg8 {
#define PG8_LAS __attribute__((address_space(3)))
typedef unsigned short bf16_t;
typedef short bf16x8 __attribute__((ext_vector_type(8)));
typedef float f32x4 __attribute__((ext_vector_type(4)));
typedef unsigned u32x4 __attribute__((ext_vector_type(4)));
constexpr int BM = 256, BK = 64, HALF = 128, HTB = HALF * BK * 2  , STAGE_BYTES = 8 * HTB, NXCD = 8, WGM = 8;

__host__ __device__ __forceinline__ int lds_byte(int r, int c) { const int st = (r >> 4) * 2 + (c >> 5), rr = r & 15, cc = c & 31, ob = rr * 64 + cc * 2; return st * 1024 + (ob ^ (((ob >> 9) & 1) << 5)); }
__host__ __device__ __forceinline__ void stage_rc(int b, int& R, int& C) { const int st = b / 1024, sb = b % 1024, swz = sb ^ (((sb >> 9) & 1) << 5); R = (st >> 1) * 16 + swz / 64; C = (st & 1) * 32 + (swz % 64) / 2; }
__host__ __device__ __forceinline__ int perm32(int rho) { const int n = rho >> 4, i = rho & 15; return 8 * (i >> 2) + 4 * n + (i & 3); }

struct Unit { int pm, pn; };
struct Gemm { const bf16_t* A; const bf16_t* Bt; int M, N, K; };

struct StaticOrder {
    int nM, nN, nwg, G, c;
    __host__ __device__ void init(int M, int N, int G_, int c_) { nM = M / BM; nN = N / BM; nwg = nM * nN; G = G_; c = c_; }
    __host__ __device__ bool next(int i, Unit& u) const {
        const long L = (long)i * G + c; if (L >= nwg) return false;
        int wgid = (int)L; { const int q = nwg / NXCD, r = nwg % NXCD, xcd = wgid % NXCD, off = wgid / NXCD; wgid = (xcd < r ? xcd * (q + 1) : r * (q + 1) + (xcd - r) * q) + off; }
        const int nig = WGM * nN, gid = wgid / nig, fm = gid * WGM, gsz = (nM - fm) < WGM ? (nM - fm) : WGM;
        u.pm = fm + ((wgid % nig) % gsz); u.pn = (wgid % nig) / gsz; return true;
    }
    __device__ __forceinline__ void a_ready(const Unit&) const {}
    __device__ __forceinline__ void done(const Unit&) const {}
};

__device__ __forceinline__ unsigned cvt_pk_bf16(float lo, float hi) { unsigned r; asm volatile("v_cvt_pk_bf16_f32 %0, %1, %2" : "=v"(r) : "v"(lo), "v"(hi)); return r; }
typedef float f32x2 __attribute__((ext_vector_type(2)));

typedef float f32x2 __attribute__((ext_vector_type(2)));
constexpr int EP_MP = 32768;
constexpr float QSCALE = 0.125f * 1.4426950408889634f;
__device__ __forceinline__ float gelu_t(float x) {
    const float t = x * (1.0f + 0.044715f * x * x);
    const float e = __builtin_amdgcn_exp2f(-2.3022081986f * t);
    return x * __builtin_amdgcn_rcpf(1.0f + e);
}
struct EpiIn {
    static constexpr bool PERM = true, AFTER_DRAIN = false;
    bf16_t *UGQ, *KV; size_t stride; float *wkp, *wvp, *wks, *wvs;
    __device__ __forceinline__ void operator()(const f32x4 (&acc)[2][2][4][2], const Unit& u, int wr, int wc, int fr, int fq) const {
        const int pn = u.pn, row0 = u.pm * BM + wr * 64 + fr, cw = wc * 32 + 8 * fq;
        if (pn < 6) {
            bf16_t* base = UGQ + (size_t)(pn >> 1) * stride;
            const unsigned off0 = (unsigned)row0 * 512u + (unsigned)((pn & 1) * 256 + cw);
#pragma unroll
            for (int ai = 0; ai < 2; ++ai)
#pragma unroll
                for (int m = 0; m < 4; ++m) { bf16_t* rowp = base + (off0 + (unsigned)(ai * HALF + m * 16) * 512u);
#pragma unroll
                    for (int bj = 0; bj < 2; ++bj) { f32x4 v0 = acc[ai][bj][m][0], v1 = acc[ai][bj][m][1];
                        if (pn < 4) {
#pragma unroll
                            for (int i = 0; i < 4; ++i) { v0[i] = gelu_t(v0[i]); v1[i] = gelu_t(v1[i]); }
                        } else { v0 = v0 * QSCALE; v1 = v1 * QSCALE; }
                        u32x4 w; w.x = cvt_pk_bf16(v0[0], v0[1]); w.y = cvt_pk_bf16(v0[2], v0[3]); w.z = cvt_pk_bf16(v1[0], v1[1]); w.w = cvt_pk_bf16(v1[2], v1[3]);
                        *(u32x4*)(rowp + bj * HALF) = w; }
                    asm volatile("" ::: "memory"); }
        } else {
            const int rowt = u.pm * BM + wr * 64;
#pragma unroll
            for (int ai = 0; ai < 2; ++ai)
#pragma unroll
                for (int m = 0; m < 4; ++m) { const int rg = rowt + ai * HALF + m * 16, row = rg + fr; bf16_t* rowp = KV + ((unsigned)row * 256u + (unsigned)cw);
                    float* wk = nullptr; float* wv = nullptr;
                    if (rg >= EP_MP) { const int s = row - EP_MP; const unsigned o = ((unsigned)(s >> 2) * 128u + 124u + (unsigned)(s & 3)) * 128u + (unsigned)cw; wk = wks + o; wv = wvs + o; }
                    else if ((rg & 8191) >= 8064) { const unsigned o = ((unsigned)(rg >> 13) * 128u + (unsigned)((row & 8191) - 8064)) * 128u + (unsigned)cw; wk = wkp + o; wv = wvp + o; }
#pragma unroll
                    for (int bj = 0; bj < 2; ++bj) { const f32x4 v0 = acc[ai][bj][m][0], v1 = acc[ai][bj][m][1];
                        u32x4 w; w.x = cvt_pk_bf16(v0[0], v0[1]); w.y = cvt_pk_bf16(v0[2], v0[3]); w.z = cvt_pk_bf16(v1[0], v1[1]); w.w = cvt_pk_bf16(v1[2], v1[3]);
                        *(u32x4*)(rowp + bj * HALF) = w;
                        if (wk) { float* d = bj ? wv : wk; *(f32x4*)d = v0; *(f32x4*)(d + 4) = v1; } }
                    asm volatile("" ::: "memory"); }
        }
    }
};
struct EpiF32 {
    static constexpr bool PERM = false, AFTER_DRAIN = false;
    float* O; int ldc;
    __device__ __forceinline__ void operator()(const f32x4 (&acc)[2][2][4][2], const Unit& u, int wr, int wc, int fr, int fq) const {
        const int row0 = u.pm * BM + wr * 64 + fr, col0 = u.pn * BM + wc * 32 + 4 * fq;
#pragma unroll
        for (int ai = 0; ai < 2; ++ai)
#pragma unroll
            for (int m = 0; m < 4; ++m) { float* rowp = O + (size_t)(row0 + ai * HALF + m * 16) * ldc + col0;
#pragma unroll
                for (int bj = 0; bj < 2; ++bj)
#pragma unroll
                    for (int n = 0; n < 2; ++n) *(f32x4*)(rowp + bj * HALF + n * 16) = acc[ai][bj][m][n]; }
    }
};
struct EpiRelu2 {
    static constexpr bool PERM = true, AFTER_DRAIN = false;
    bf16_t* O; int ldc;
    __device__ __forceinline__ void operator()(const f32x4 (&acc)[2][2][4][2], const Unit& u, int wr, int wc, int fr, int fq) const {
        const int row0 = u.pm * BM + wr * 64 + fr, col0 = u.pn * BM + wc * 32 + 8 * fq;
#pragma unroll
        for (int ai = 0; ai < 2; ++ai)
#pragma unroll
            for (int m = 0; m < 4; ++m) { bf16_t* rowp = O + (size_t)(row0 + ai * HALF + m * 16) * ldc + col0;
#pragma unroll
                for (int bj = 0; bj < 2; ++bj) { f32x4 v0 = acc[ai][bj][m][0], v1 = acc[ai][bj][m][1];
#pragma unroll
                    for (int i = 0; i < 4; ++i) { const float a = fmaxf(v0[i], 0.f), b = fmaxf(v1[i], 0.f); v0[i] = a * a; v1[i] = b * b; }
                    u32x4 w; w.x = cvt_pk_bf16(v0[0], v0[1]); w.y = cvt_pk_bf16(v0[2], v0[3]); w.z = cvt_pk_bf16(v1[0], v1[1]); w.w = cvt_pk_bf16(v1[2], v1[3]);
                    *(u32x4*)(rowp + bj * HALF) = w; } }
    }
};

template <class Epi, class Sched, bool ALIGN_EPI = false, bool SP2 = false>
__device__ __forceinline__ void gemm_phase(PG8_LAS unsigned char* lds, const Gemm g, const Sched& S, const Epi& E) {
    const int tid = threadIdx.x, wid = __builtin_amdgcn_readfirstlane(tid >> 6), lane = tid & 63, wr = wid >> 2, wc = wid & 3, fr = lane & 15, fq = lane >> 4;
    const int K = g.K, nt = K / BK;
    unsigned voffA[2], voffB[2];
#pragma unroll
    for (int i = 0; i < 2; ++i) { int R, C; stage_rc(tid * 16 + i * 8192, R, C); const int Rb = Epi::PERM ? ((R & ~31) + perm32(R & 31)) : R;
        voffA[i] = (unsigned)(R * K + C) * 2u; voffB[i] = (unsigned)(Rb * K + C) * 2u; }
    const size_t kstep = (size_t)(BK * 2);
    const size_t hstep = (size_t)HALF * K * 2;
    const size_t tstep = 2 * hstep;
    const unsigned ldsw = (unsigned)wid * 1024u;
    const int aoff = lds_byte(wr * 64 + fr, fq * 8), boff = lds_byte(wc * 32 + fr, fq * 8);
#define PG8_SA(b, h) (((b) * 2 + (h)) * HTB)
#define PG8_SB(b, h) ((4 + (b) * 2 + (h)) * HTB)
#define PG8_STAGE(bufoff, gbase, voff) do { _Pragma("unroll") for (int _i = 0; _i < 2; ++_i) \
        __builtin_amdgcn_global_load_lds((const unsigned*)((const char*)(gbase) + (voff)[_i]), (PG8_LAS unsigned*)(lds + (bufoff) + ldsw + _i * 8192), 16, 0, 0); } while (0)
#define PG8_LDA(dst, b, h) do { _Pragma("unroll") for (int m = 0; m < 4; ++m) _Pragma("unroll") for (int k = 0; k < 2; ++k) dst[m][k] = *(const PG8_LAS bf16x8*)(lds + PG8_SA(b, h) + aoff + m * 2048 + k * 1024); } while (0)
#define PG8_LDB(dst, b, h) do { _Pragma("unroll") for (int n = 0; n < 2; ++n) _Pragma("unroll") for (int k = 0; k < 2; ++k) dst[n][k] = *(const PG8_LAS bf16x8*)(lds + PG8_SB(b, h) + boff + n * 2048 + k * 1024); } while (0)
#define PG8_MMA(ai, bj, At, Bt) do { __builtin_amdgcn_s_setprio(1); _Pragma("unroll") for (int m = 0; m < 4; ++m) _Pragma("unroll") for (int n = 0; n < 2; ++n) _Pragma("unroll") for (int k = 0; k < 2; ++k) \
        acc[ai][bj][m][n] = __builtin_amdgcn_mfma_f32_16x16x32_bf16(Bt[n][k], At[m][k], acc[ai][bj][m][n], 0, 0, 0); __builtin_amdgcn_s_setprio(0); } while (0)
#define PG8_WAIT_V(n) asm volatile("s_waitcnt vmcnt(" #n ")" ::: "memory")
#define PG8_WAIT_L(n) asm volatile("s_waitcnt lgkmcnt(" #n ")" ::: "memory")
#define PG8_BAR __builtin_amdgcn_s_barrier()
#define PG8_SCHED __builtin_amdgcn_sched_barrier(0)
    Unit cur, nxt; int ui = 0;
    if (!S.next(0, cur)) return;
    f32x4 acc[2][2][4][2];
#pragma unroll
    for (int a = 0; a < 2; ++a)
#pragma unroll
        for (int b = 0; b < 2; ++b)
#pragma unroll
            for (int m = 0; m < 4; ++m)
#pragma unroll
                for (int n = 0; n < 2; ++n) acc[a][b][m][n] = (f32x4){0.f, 0.f, 0.f, 0.f};
    bf16x8 At[4][2], B0[2][2], B1[2][2];
    const char* cA = (const char*)g.A + (size_t)cur.pm * tstep; const char* cB = (const char*)g.Bt + (size_t)cur.pn * tstep;
    S.a_ready(cur);
    if constexpr (SP2) {
        PG8_STAGE(PG8_SB(0, 0), cB, voffB); PG8_STAGE(PG8_SB(0, 1), cB + hstep, voffB); PG8_STAGE(PG8_SA(0, 0), cA, voffA); PG8_STAGE(PG8_SA(0, 1), cA + hstep, voffA);
        if (wr == 1) PG8_BAR;
        PG8_WAIT_V(2); PG8_BAR;
        PG8_STAGE(PG8_SB(1, 0), cB + kstep, voffB); PG8_STAGE(PG8_SA(1, 0), cA + kstep, voffA); PG8_STAGE(PG8_SB(1, 1), cB + hstep + kstep, voffB);
        PG8_WAIT_V(6); PG8_BAR;
    } else {
        PG8_STAGE(PG8_SB(0, 0), cB, voffB); PG8_STAGE(PG8_SA(0, 0), cA, voffA); PG8_STAGE(PG8_SB(0, 1), cB + hstep, voffB); PG8_STAGE(PG8_SA(0, 1), cA + hstep, voffA);
        if (wr == 1) PG8_BAR;
        PG8_WAIT_V(4); PG8_BAR;
        PG8_STAGE(PG8_SB(1, 0), cB + kstep, voffB); PG8_STAGE(PG8_SA(1, 0), cA + kstep, voffA); PG8_STAGE(PG8_SB(1, 1), cB + hstep + kstep, voffB);
        PG8_WAIT_V(6); PG8_BAR;
    }
    for (;;) {
        const bool has_next = S.next(ui + 1, nxt);
        const char* nA = has_next ? (const char*)g.A + (size_t)nxt.pm * tstep : cA; const char* nB = has_next ? (const char*)g.Bt + (size_t)nxt.pn * tstep : cB;
        for (int t = 0; t < nt; t += 2) {
            const bool last = (t == nt - 2);
            const char* a1 = cA + (size_t)(t + 1) * kstep;
            const char* a2 = last ? nA : cA + (size_t)(t + 2) * kstep; const char* b2 = last ? nB : cB + (size_t)(t + 2) * kstep;
            const char* a3 = a2 + kstep; const char* b3 = b2 + kstep;
            if (last && has_next) S.a_ready(nxt);
            if constexpr (SP2) {
            PG8_LDB(B0, 0, 0); PG8_LDB(B1, 0, 1); PG8_SCHED; PG8_LDA(At, 0, 0); PG8_STAGE(PG8_SA(1, 1), a1 + hstep, voffA);
            PG8_WAIT_V(8); PG8_WAIT_L(0); PG8_BAR; PG8_MMA(0, 0, At, B0); PG8_MMA(0, 1, At, B1); PG8_BAR; PG8_SCHED;
            PG8_LDA(At, 0, 1); PG8_STAGE(PG8_SB(0, 0), b2, voffB); PG8_STAGE(PG8_SB(0, 1), b2 + hstep, voffB); PG8_STAGE(PG8_SA(0, 0), a2, voffA);
            PG8_WAIT_V(8); PG8_WAIT_L(0); PG8_BAR; PG8_MMA(1, 0, At, B0); PG8_MMA(1, 1, At, B1); PG8_BAR; PG8_SCHED;
            PG8_LDB(B0, 1, 0); PG8_LDB(B1, 1, 1); PG8_SCHED; PG8_LDA(At, 1, 0); PG8_STAGE(PG8_SA(0, 1), a2 + hstep, voffA);
            PG8_WAIT_V(8); PG8_WAIT_L(0); PG8_BAR; PG8_MMA(0, 0, At, B0); PG8_MMA(0, 1, At, B1); PG8_BAR; PG8_SCHED;
            PG8_LDA(At, 1, 1); PG8_STAGE(PG8_SB(1, 0), b3, voffB); PG8_STAGE(PG8_SB(1, 1), b3 + hstep, voffB); PG8_STAGE(PG8_SA(1, 0), a3, voffA);
            PG8_WAIT_V(8); PG8_WAIT_L(0); PG8_BAR; PG8_MMA(1, 0, At, B0); PG8_MMA(1, 1, At, B1); PG8_BAR; PG8_SCHED;
            } else {
            PG8_LDB(B0, 0, 0); PG8_SCHED; PG8_LDA(At, 0, 0); PG8_STAGE(PG8_SA(1, 1), a1 + hstep, voffA);
            PG8_WAIT_L(8); PG8_BAR; PG8_WAIT_L(0); PG8_MMA(0, 0, At, B0); PG8_BAR; PG8_SCHED;
            PG8_LDB(B1, 0, 1); PG8_STAGE(PG8_SB(0, 0), b2, voffB);
            PG8_BAR; PG8_WAIT_L(0); PG8_MMA(0, 1, At, B1); PG8_BAR;
            PG8_LDA(At, 0, 1); PG8_STAGE(PG8_SA(0, 0), a2, voffA);
            PG8_BAR; PG8_WAIT_L(0); PG8_MMA(1, 0, At, B0); PG8_BAR; PG8_SCHED;
            PG8_STAGE(PG8_SB(0, 1), b2 + hstep, voffB);
            PG8_WAIT_V(6); PG8_BAR; PG8_MMA(1, 1, At, B1); PG8_BAR;
            PG8_LDB(B0, 1, 0); PG8_SCHED; PG8_LDA(At, 1, 0); PG8_STAGE(PG8_SA(0, 1), a2 + hstep, voffA);
            PG8_WAIT_L(8); PG8_BAR; PG8_WAIT_L(0); PG8_MMA(0, 0, At, B0); PG8_BAR; PG8_SCHED;
            PG8_LDB(B1, 1, 1); PG8_STAGE(PG8_SB(1, 0), b3, voffB);
            PG8_BAR; PG8_WAIT_L(0); PG8_MMA(0, 1, At, B1); PG8_BAR;
            PG8_LDA(At, 1, 1); PG8_STAGE(PG8_SA(1, 0), a3, voffA);
            PG8_BAR; PG8_WAIT_L(0); PG8_MMA(1, 0, At, B0); PG8_BAR; PG8_SCHED;
            PG8_STAGE(PG8_SB(1, 1), b3 + hstep, voffB);
            PG8_WAIT_V(6); PG8_BAR; PG8_MMA(1, 1, At, B1); PG8_BAR;
            }
        }
        if constexpr (ALIGN_EPI) { if (wr == 0) PG8_BAR; }
        if constexpr (!Epi::AFTER_DRAIN) { E(acc, cur, wr, wc, fr, fq); S.done(cur); }
        if (!has_next) break;
#pragma unroll
        for (int a = 0; a < 2; ++a)
#pragma unroll
            for (int b = 0; b < 2; ++b)
#pragma unroll
                for (int m = 0; m < 4; ++m)
#pragma unroll
                    for (int n = 0; n < 2; ++n) acc[a][b][m][n] = (f32x4){0.f, 0.f, 0.f, 0.f};
        cur = nxt; cA = nA; cB = nB; ++ui;
        if constexpr (ALIGN_EPI) { if (wr == 1) PG8_BAR; }
    }
    PG8_WAIT_V(0);
    if constexpr (!ALIGN_EPI) { if (wr == 0) PG8_BAR; }
    PG8_BAR;
    if constexpr (Epi::AFTER_DRAIN) { E.fused(acc, cur, wr, wc, fr, fq, lds, wid, lane); S.done(cur); }
#undef PG8_SA
#undef PG8_SB
#undef PG8_STAGE
#undef PG8_LDA
#undef PG8_LDB
#undef PG8_MMA
#undef PG8_WAIT_V
#undef PG8_WAIT_L
#undef PG8_BAR
#undef PG8_SCHED
}
}

#ifndef PG8_SP2
#define PG8_SP2 true
#endif
#ifndef PG8_ALIGN
#define PG8_ALIGN true
#endif

#define GAS __attribute__((address_space(1)))
#define LAS __attribute__((address_space(3)))
typedef unsigned short bf16;
typedef unsigned v4u __attribute__((ext_vector_type(4)));
typedef float f32x4 __attribute__((ext_vector_type(4)));
typedef short bf16x8 __attribute__((ext_vector_type(8)));
typedef GAS unsigned gu32;
typedef GAS unsigned long long gu64;
#define RLX_AGENT __ATOMIC_RELAXED, __HIP_MEMORY_SCOPE_AGENT
#define LDS_WAIT() asm volatile("s_waitcnt lgkmcnt(0)" ::: "memory")
#define VM_WAIT() asm volatile("s_waitcnt vmcnt(0)" ::: "memory")
__device__ __forceinline__ unsigned long long rt() { return __builtin_amdgcn_s_memrealtime(); }
__device__ __forceinline__ unsigned f2bf(float f) { unsigned u = __builtin_bit_cast(unsigned, f); return (u + 0x7fffu + ((u >> 16) & 1u)) >> 16; }
__device__ __forceinline__ unsigned pk2(float lo, float hi) { return f2bf(lo) | (f2bf(hi) << 16); }

#define XB_TMO      128
#define XB_XCNT(j)  (256  + 64 * (j))
#define XB_XSUB(j)  (1280 + 64 * (j))
#define XB_XGEN(j)  (2304 + 64 * (j))
#define XB_TOP      3328
#define XB_TOPGEN   3392
#define XCD_BAR_WORDS 3456
#define XB_SPIN_CAP (1u << 18)

__device__ __forceinline__ unsigned xb_ld(unsigned* p)              { return __hip_atomic_load(p, __ATOMIC_RELAXED, __HIP_MEMORY_SCOPE_AGENT); }
__device__ __forceinline__ unsigned xb_add(unsigned* p, unsigned v) { return __hip_atomic_fetch_add(p, v, __ATOMIC_RELAXED, __HIP_MEMORY_SCOPE_AGENT); }
__device__ __forceinline__ unsigned xb_xcc_id() { return (unsigned)__builtin_amdgcn_s_getreg((3 << 11) | 20) & 0xFu; }
#define XB_SPIN(cond, bar) do { unsigned _sp = 0; while (cond) { __builtin_amdgcn_s_sleep(1); \
    if ((++_sp & 255u) == 0u) { if (xb_ld(&(bar)[XB_TMO])) break; if (_sp > XB_SPIN_CAP) { atomicAdd(&(bar)[XB_TMO], 1u); break; } } } } while (0)

struct XcdBarrier {
    unsigned* bar; unsigned x;
    volatile LAS unsigned* st;
};

__device__ __forceinline__ XcdBarrier xcd_barrier_post(unsigned* bar, volatile LAS unsigned* st) {
    XcdBarrier b; b.bar = bar; b.x = xb_xcc_id(); b.st = st;
    if (threadIdx.x == 0) (void)xb_add(&bar[XB_XCNT(b.x)], 1u);
    return b;
}
__device__ __forceinline__ void xcd_barrier_complete(unsigned* bar, unsigned x, unsigned& nloc, unsigned& nx) {
    const unsigned G = gridDim.x * gridDim.y * gridDim.z;
    unsigned sum, cnt, mine, sp = 0u;
    for (;;) {
        sum = 0u; cnt = 0u; mine = 0u;
#pragma unroll
        for (unsigned j = 0; j < 16; ++j) { const unsigned c = xb_ld(&bar[XB_XCNT(j)]); sum += c; cnt += (c > 0u) ? 1u : 0u; mine = (j == x) ? c : mine; }
        if (sum == G) break;
        __builtin_amdgcn_s_sleep(1);
        if ((++sp & 255u) == 0u) { if (xb_ld(&bar[XB_TMO])) break; if (sp > XB_SPIN_CAP) { atomicAdd(&bar[XB_TMO], 1u); break; } }
    }
    nloc = mine > 0u ? mine : 1u; nx = cnt > 0u ? cnt : 1u;
}

__device__ __forceinline__ void xcd_barrier(const XcdBarrier& b) {
    asm volatile("s_waitcnt vmcnt(0)" ::: "memory");
    __syncthreads();
    if (threadIdx.x == 0) {
        unsigned* bar = b.bar;
        __builtin_amdgcn_s_waitcnt(0);
        unsigned nloc = b.st[0], nx = b.st[1];
        if (nloc == 0u) { xcd_barrier_complete(bar, b.x, nloc, nx); b.st[0] = nloc; b.st[1] = nx; }
        const unsigned old = xb_add(&bar[XB_XSUB(b.x)], 1u);
        const unsigned gen = old / nloc;
        if (old + 1u == (gen + 1u) * nloc) {
            __builtin_amdgcn_fence(__ATOMIC_RELEASE, "agent");
            asm volatile("s_waitcnt vmcnt(0)" ::: "memory");
            const unsigned og = xb_add(&bar[XB_TOP], 1u);
            const unsigned tg = og / nx;
            if (og + 1u == (tg + 1u) * nx) xb_add(&bar[XB_TOPGEN], 1u);
            else XB_SPIN(xb_ld(&bar[XB_TOPGEN]) == tg, bar);
            __builtin_amdgcn_fence(__ATOMIC_ACQUIRE, "agent");
            xb_add(&bar[XB_XGEN(b.x)], 1u);
            asm volatile("s_waitcnt vmcnt(0)" ::: "memory");
        } else {
            XB_SPIN(xb_ld(&bar[XB_XGEN(b.x)]) == gen, bar);
            __builtin_amdgcn_fence(__ATOMIC_ACQUIRE, "agent");
            asm volatile("s_waitcnt vmcnt(0)" ::: "memory");
        }
    }
    __syncthreads();
}

constexpr int NWAVES = 8;
constexpr int D = 1024, MP = 32768, MS = 512, M = MP + MS, SEQ = 8192, NBATCH = 4, DB = 128;
constexpr int INW = 1792, CW = 512, FF = 4096;
constexpr float EPS = 1e-6f, LOG2E = 1.4426950408889634f;
constexpr size_t MiB = 1u << 20;
constexpr size_t WS_CTL = 0, CTL_ZERO_BYTES = 1 * MiB;
constexpr size_t WS_WIN = 2 * MiB;
constexpr size_t WS_WO = WS_WIN + 4 * MiB;
constexpr size_t WS_WUP = WS_WO + 2 * MiB;
constexpr size_t WS_WDN = WS_WUP + 8 * MiB;
constexpr size_t WS_WSP = WS_WDN + 8 * MiB;
constexpr size_t WS_CKV = 26 * MiB;
constexpr size_t WS_XN = 34 * MiB;
constexpr size_t WS_U = 99 * MiB;
constexpr size_t WS_GV = WS_U + 33 * MiB;
constexpr size_t WS_Q = WS_GV + 33 * MiB;
constexpr size_t WS_KV = WS_Q + 33 * MiB;
constexpr size_t WS_MG = WS_KV + 17 * MiB;
constexpr size_t WS_H = 99 * MiB;
constexpr size_t WS_OF = 360 * MiB;
constexpr size_t WS_END = 490 * MiB;
static_assert(WS_WSP + 512 * 1024 <= WS_CKV && WS_CKV + 8 * MiB <= WS_XN && WS_XN + (size_t)M * D * 2 <= WS_U && WS_MG + (size_t)M * D * 2 <= WS_OF && WS_H + (size_t)M * FF * 2 <= WS_OF && WS_OF + (size_t)M * D * 4 <= WS_END, "d_ws map");
constexpr int CW_BAR = 4096;
constexpr int SCR_BYTES = 147456;
constexpr int MISC_OFF = SCR_BYTES, LDS_BYTES = SCR_BYTES + 1024;
constexpr int IMG_PITCH = 1088;
constexpr int KIMG = 0, VIMG = 65536, OST = 131072;

typedef unsigned short bf16;
typedef short s16x4 __attribute__((ext_vector_type(4)));
typedef float f32x16 __attribute__((ext_vector_type(16)));
typedef float f32x2 __attribute__((ext_vector_type(2)));
typedef __bf16 bf16x2_t __attribute__((ext_vector_type(2)));
__device__ __forceinline__ unsigned cvtpk(float lo, float hi) { f32x2 v = {lo, hi}; bf16x2_t b = __builtin_convertvector(v, bf16x2_t); return __builtin_bit_cast(unsigned, b); }
__device__ __forceinline__ float bflo(unsigned w) { return __uint_as_float(w << 16); }
__device__ __forceinline__ float bfhi(unsigned w) { return __uint_as_float(w & 0xffff0000u); }
__device__ __forceinline__ s16x4 vtr(LAS unsigned char* p) { return __builtin_bit_cast(s16x4, __builtin_amdgcn_ds_read_tr16_b64_v4i16((LAS s16x4*)p)); }
__device__ __forceinline__ int crow(int r, int h) { return (r & 3) + 8 * (r >> 2) + 4 * h; }
__device__ __forceinline__ float wave_sum(float v) {
#pragma unroll
    for (int o = 1; o < 64; o <<= 1) v += __shfl_xor(v, o);
    return v;
}

struct Frame {
    LAS unsigned char* lds;
    int tid, lane, wave, vcu, G;
    const float *xp, *xs, *ck, *cv, *w_in, *g_pre, *lng, *lnb, *wsp, *bsp, *sinks, *goc, *goa, *w_o, *gpm, *gpf, *w_up, *w_dn, *gpo;
    float *y, *wkp, *wvp, *cvp, *wks, *wvs, *cvs;
    bf16 *Wt_in, *Wt_o, *Wt_up, *Wt_dn, *WSP16, *WSPS16, *CKV16, *XN, *U, *GV, *Q, *KV, *MG, *H;
    float* OF;
};

__device__ __forceinline__ void p0_transpose_item(const float* W, int K, int N, bf16* WT, LAS float* scr, int item, int lane) {
    const int nblk = N / 32, kb = item / nblk, nb = item % nblk, k0 = 64 * kb, n0 = 32 * nb;
#pragma unroll 8
    for (int i = 0; i < 32; ++i) { const int kk = 2 * i + (lane >> 5); scr[kk * 33 + (lane & 31)] = W[(size_t)(k0 + kk) * N + n0 + (lane & 31)]; }
    LDS_WAIT(); asm volatile("" ::: "memory");
    const int c = lane & 7;
#pragma unroll
    for (int j = 0; j < 4; ++j) { const int n = (lane >> 3) + 8 * j; const LAS float* s = scr + (8 * c) * 33 + n;
        v4u o; o.x = cvtpk(s[0 * 33], s[1 * 33]); o.y = cvtpk(s[2 * 33], s[3 * 33]); o.z = cvtpk(s[4 * 33], s[5 * 33]); o.w = cvtpk(s[6 * 33], s[7 * 33]);
        *(GAS v4u*)(WT + (size_t)(n0 + n) * K + k0 + 8 * c) = o; }
    LDS_WAIT(); asm volatile("" ::: "memory");
}
__device__ __forceinline__ void rms_row_to_bf16(const float* xrow, const float* g, bf16* orow, int lane) {
    const GAS f32x4* xr = (const GAS f32x4*)xrow + lane; const GAS f32x4* gr = (const GAS f32x4*)g + lane;
    f32x4 v[4]; float s = 0.f;
#pragma unroll
    for (int j = 0; j < 4; ++j) { v[j] = xr[64 * j]; s += (v[j].x * v[j].x + v[j].y * v[j].y) + (v[j].z * v[j].z + v[j].w * v[j].w); }
    const float r = rsqrtf(wave_sum(s) * (1.f / D) + EPS);
    GAS unsigned long long* o8 = (GAS unsigned long long*)orow + lane;
#pragma unroll
    for (int j = 0; j < 4; ++j) { const f32x4 gg = gr[64 * j];
        o8[64 * j] = (unsigned long long)cvtpk(v[j].x * r * gg.x, v[j].y * r * gg.y) | ((unsigned long long)cvtpk(v[j].z * r * gg.z, v[j].w * r * gg.w) << 32); }
}
__device__ __forceinline__ void p0_prologue(Frame& F) {
    LAS float* scr = (LAS float*)(F.lds + F.wave * 16384);
    const int gw = F.vcu * NWAVES + F.wave, NGW = F.G * NWAVES;
    constexpr int I_IN = (D / 64) * (INW / 32), I_O = (D / 64) * (D / 32), I_UP = (D / 64) * (FF / 32), I_DN = (FF / 64) * (D / 32);
    constexpr int NITEMS = I_IN + I_O + I_UP + I_DN;
    for (int it = gw; it < NITEMS; it += NGW) {
        int r = it;
        if (r < I_IN) { p0_transpose_item(F.w_in, D, INW, F.Wt_in, scr, r, F.lane); continue; } r -= I_IN;
        if (r < I_O) { p0_transpose_item(F.w_o, D, D, F.Wt_o, scr, r, F.lane); continue; } r -= I_O;
        if (r < I_UP) { p0_transpose_item(F.w_up, D, FF, F.Wt_up, scr, r, F.lane); continue; } r -= I_UP;
        p0_transpose_item(F.w_dn, FF, D, F.Wt_dn, scr, r, F.lane);
    }
    for (int m = gw; m < M; m += NGW) rms_row_to_bf16(m < MP ? F.xp + (size_t)m * D : F.xs + (size_t)(m - MP) * D, F.g_pre, F.XN + (size_t)m * D, F.lane);
    const int gt = F.vcu * (NWAVES * 64) + F.tid, NGT = F.G * NWAVES * 64;
    for (int e = gt; e < 8 * 128 * 128; e += NGT) { const int s = e & 127, t = (e >> 7) & 127, g = e >> 14;
        const float w = F.wsp[e]; F.WSP16[e] = (bf16)(cvtpk(s <= t ? w : 0.f, 0.f) & 0xffffu);
        const int tl = t & 3, sl = s & 3; const float w2 = ((t >> 2) == (s >> 2) && sl <= tl) ? F.wsp[(g * 128 + tl) * 128 + sl] : 0.f;
        F.WSPS16[e] = (bf16)(cvtpk(w2, 0.f) & 0xffffu); }
    for (int e = gt; e < DB * 128 * 16; e += NGT) { const int c8 = (e & 15) * 8, row = (e >> 4) & 127, bd = e >> 11;
        const size_t src = ((size_t)bd * 128 + row) * 128 + c8;
        const f32x4 k0 = *(const GAS f32x4*)(F.ck + src), k1 = *(const GAS f32x4*)(F.ck + src + 4), v0 = *(const GAS f32x4*)(F.cv + src), v1 = *(const GAS f32x4*)(F.cv + src + 4);
        v4u kw, vw; kw.x = cvtpk(k0.x, k0.y); kw.y = cvtpk(k0.z, k0.w); kw.z = cvtpk(k1.x, k1.y); kw.w = cvtpk(k1.z, k1.w);
        vw.x = cvtpk(v0.x, v0.y); vw.y = cvtpk(v0.z, v0.w); vw.z = cvtpk(v1.x, v1.y); vw.w = cvtpk(v1.z, v1.w);
        bf16* dst = F.CKV16 + ((size_t)bd * 128 + row) * 256 + c8;
        *(GAS v4u*)dst = kw; *(GAS v4u*)(dst + 128) = vw;
        if (row >= 4) { const size_t o = ((size_t)bd * 128 + row - 4) * 128 + c8;
            *(GAS f32x4*)(F.wks + o) = k0; *(GAS f32x4*)(F.wks + o + 4) = k1; *(GAS f32x4*)(F.wvs + o) = v0; *(GAS f32x4*)(F.wvs + o + 4) = v1; } }
}

__device__ __forceinline__ void mixer_a(Frame& F, int m0, const bf16* W16, int bias_mask, float* cv_out) {
    LAS unsigned char* img = F.lds; const int lane = F.lane, w = F.wave;
    {
        const f32x4 g0 = *(const GAS f32x4*)(F.lng + 8 * lane), g1 = *(const GAS f32x4*)(F.lng + 8 * lane + 4), b0 = *(const GAS f32x4*)(F.lnb + 8 * lane), b1 = *(const GAS f32x4*)(F.lnb + 8 * lane + 4);
#pragma unroll 4
        for (int i = 0; i < 16; ++i) { const int s = 16 * w + i;
            const v4u raw = *(const GAS v4u*)(F.GV + (size_t)(m0 + s) * CW + 8 * lane);
            float x[8] = {bflo(raw.x), bfhi(raw.x), bflo(raw.y), bfhi(raw.y), bflo(raw.z), bfhi(raw.z), bflo(raw.w), bfhi(raw.w)};
            float sm = 0.f;
#pragma unroll
            for (int k = 0; k < 8; ++k) sm += x[k];
            const float mean = wave_sum(sm) * (1.f / CW); float q = 0.f;
#pragma unroll
            for (int k = 0; k < 8; ++k) { x[k] -= mean; q += x[k] * x[k]; }
            const float r = rsqrtf(wave_sum(q) * (1.f / CW) + EPS);
            f32x4 y0 = {x[0] * r * g0.x + b0.x, x[1] * r * g0.y + b0.y, x[2] * r * g0.z + b0.z, x[3] * r * g0.w + b0.w};
            f32x4 y1 = {x[4] * r * g1.x + b1.x, x[5] * r * g1.y + b1.y, x[6] * r * g1.z + b1.z, x[7] * r * g1.w + b1.w};
            if (cv_out) { *(GAS f32x4*)(cv_out + (size_t)s * CW + 8 * lane) = y0; *(GAS f32x4*)(cv_out + (size_t)s * CW + 8 * lane + 4) = y1; }
            v4u o; o.x = cvtpk(y0.x, y0.y); o.y = cvtpk(y0.z, y0.w); o.z = cvtpk(y1.x, y1.y); o.w = cvtpk(y1.z, y1.w);
            *(LAS v4u*)(img + s * IMG_PITCH + lane * 16) = o; }
    }
    __syncthreads();
    {
        const int g = w, r32 = lane & 31, h = lane >> 5, i16 = (lane >> 4) & 1, q = (lane & 15) >> 2, p = lane & 3;
        const bf16* wrow = W16 + (size_t)g * 128 * 128 + (size_t)r32 * 128 + 8 * h;
        LAS unsigned char* trb = img + (8 * h + q) * IMG_PITCH + (64 * g + 16 * i16 + 4 * p) * 2;
        const float* bias = F.bsp + g * 128;
#pragma unroll 1
        for (int tb = 3; tb >= 0; --tb) {
            f32x16 acc0 = {}, acc1 = {};
#pragma unroll 2
            for (int ks = 0; ks <= 2 * tb + 1; ++ks) {
                const bf16x8 a = *(const GAS bf16x8*)(wrow + (size_t)(32 * tb) * 128 + 16 * ks);
                LAS unsigned char* tp = trb + ks * 16 * IMG_PITCH;
                const s16x4 l0 = vtr(tp), h0 = vtr(tp + 4 * IMG_PITCH), l1 = vtr(tp + 64), h1 = vtr(tp + 4 * IMG_PITCH + 64);
                acc0 = __builtin_amdgcn_mfma_f32_32x32x16_bf16(a, __builtin_shufflevector(l0, h0, 0, 1, 2, 3, 4, 5, 6, 7), acc0, 0, 0, 0);
                acc1 = __builtin_amdgcn_mfma_f32_32x32x16_bf16(a, __builtin_shufflevector(l1, h1, 0, 1, 2, 3, 4, 5, 6, 7), acc1, 0, 0, 0);
            }
#pragma unroll
            for (int r = 0; r < 16; ++r) { const int t = 32 * tb + crow(r, h); const float bb = bias[t & bias_mask];
                LAS unsigned short* sp = (LAS unsigned short*)(img + t * IMG_PITCH + (64 * g + r32) * 2);
                sp[0] = (unsigned short)(cvtpk(acc0[r] + bb, 0.f) & 0xffffu); sp[32] = (unsigned short)(cvtpk(acc1[r] + bb, 0.f) & 0xffffu); }
        }
    }
    __syncthreads();
    {
        const f32x4 g0 = *(const GAS f32x4*)(F.goc + 8 * lane), g1 = *(const GAS f32x4*)(F.goc + 8 * lane + 4);
#pragma unroll 4
        for (int i = 0; i < 16; ++i) { const int t = 16 * w + i;
            const v4u sv = *(const LAS v4u*)(img + t * IMG_PITCH + lane * 16);
            const v4u uv = *(const GAS v4u*)(F.U + (size_t)(m0 + t) * CW + 8 * lane);
            float a[8] = {bflo(sv.x) * bflo(uv.x), bfhi(sv.x) * bfhi(uv.x), bflo(sv.y) * bflo(uv.y), bfhi(sv.y) * bfhi(uv.y), bflo(sv.z) * bflo(uv.z), bfhi(sv.z) * bfhi(uv.z), bflo(sv.w) * bflo(uv.w), bfhi(sv.w) * bfhi(uv.w)};
            float q = 0.f;
#pragma unroll
            for (int k = 0; k < 8; ++k) q += a[k] * a[k];
            const float r = rsqrtf(wave_sum(q) * (1.f / CW) + EPS);
            v4u o; o.x = cvtpk(a[0] * r * g0.x, a[1] * r * g0.y); o.y = cvtpk(a[2] * r * g0.z, a[3] * r * g0.w); o.z = cvtpk(a[4] * r * g1.x, a[5] * r * g1.y); o.w = cvtpk(a[6] * r * g1.z, a[7] * r * g1.w);
            *(GAS v4u*)(F.MG + (size_t)(m0 + t) * D + 8 * lane) = o; }
    }
    __syncthreads();
}

__device__ __forceinline__ void mixer_b(Frame& F, const bf16* kv_prev, const bf16* kv_cur, int ncur, const bf16* qrows, int nq, bool first, bf16* out) {
    LAS unsigned char* lds = F.lds; const int lane = F.lane, w = F.wave, tid = F.tid;
#pragma unroll 4
    for (int it = 0; it < 16; ++it) { const int id = it * 512 + tid, row = id >> 5, c32 = id & 31;
        v4u v = {0u, 0u, 0u, 0u};
        if (row < 128) { if (kv_prev) v = *(const GAS v4u*)(kv_prev + (size_t)row * 256 + c32 * 8); }
        else if (row - 128 < ncur) v = *(const GAS v4u*)(kv_cur + (size_t)(row - 128) * 256 + c32 * 8);
        const int kvh = (c32 >> 3) & 1, c = c32 & 7; int off;
        if (c32 < 16) off = KIMG + (kvh * 256 + row) * 128 + ((c ^ ((row >> 1) & 7)) * 16);
        else off = VIMG + (kvh * 256 + row) * 128 + (((c >> 2) ^ ((row >> 1) & 1)) * 64) + (c & 3) * 16;
        *(LAS v4u*)(lds + off) = v; }
    __syncthreads();
    {
        const int hq = w, kvh = w >> 2, r32 = lane & 31, h = lane >> 5, i16 = (lane >> 4) & 1, q = (lane & 15) >> 2, p = lane & 3;
        const float slope2 = exp2f(-(float)(hq + 1)) * LOG2E, sink2 = F.sinks[hq] * LOG2E;
        const int nqb = nq > 32 ? 4 : 1;
        LAS unsigned char* ost = lds + OST + w * 2048;
        for (int qb = 0; qb < nqb; ++qb) {
            const int a = 32 * qb + r32, arow = a < nq ? a : 0;
            const bf16* qp = qrows + (size_t)arow * CW + hq * 64 + 8 * h;
            bf16x8 qf[4];
#pragma unroll
            for (int ks = 0; ks < 4; ++ks) qf[ks] = *(const GAS bf16x8*)(qp + 16 * ks);
            f32x16 sc[5];
#pragma unroll
            for (int kb = 0; kb < 5; ++kb) { const int key = 32 * (qb + kb) + r32; const LAS unsigned char* kp = lds + KIMG + (kvh * 256 + key) * 128; const int sw = (key >> 1) & 7;
                f32x16 acc = {};
#pragma unroll
                for (int ks = 0; ks < 4; ++ks) { const bf16x8 kf = *(const LAS bf16x8*)(kp + (((2 * ks + h) ^ sw) * 16)); acc = __builtin_amdgcn_mfma_f32_32x32x16_bf16(kf, qf[ks], acc, 0, 0, 0); }
                sc[kb] = acc; }
            float mx = sink2;
            int d0 = 128 + r32 - 4 * h; asm volatile("" : "+v"(d0));
            const int c0 = 32 * qb + 4 * h; const float fd0 = (float)d0;
#pragma unroll
            for (int kb = 0; kb < 5; ++kb)
#pragma unroll
                for (int r = 0; r < 16; ++r) { const int kk = (r & 3) + 8 * (r >> 2) + 32 * kb;
                    bool valid = true;
                    if (kb == 0) valid = kk >= d0 - 128;
                    if (kb == 4) valid = kk <= d0;
                    if (kb < 4) valid = valid && !(first && (c0 + kk < 128));
                    const float s = valid ? __builtin_fmaf(slope2, (float)kk - fd0, sc[kb][r]) : -INFINITY; sc[kb][r] = s; mx = fmaxf(mx, s); }
            mx = fmaxf(mx, __shfl_xor(mx, 32));
            float sum = 0.f;
#pragma unroll
            for (int kb = 0; kb < 5; ++kb)
#pragma unroll
                for (int r = 0; r < 16; ++r) { const float pz = __builtin_amdgcn_exp2f(sc[kb][r] - mx); sc[kb][r] = pz; sum += pz; }
            sum += __shfl_xor(sum, 32);
            const float inv = 1.0f / (sum + __builtin_amdgcn_exp2f(sink2 - mx));
            f32x16 o0 = {}, o1 = {};
#pragma unroll
            for (int kb = 0; kb < 5; ++kb)
#pragma unroll
                for (int s = 0; s < 2; ++s) {
                    v4u pw; pw.x = cvtpk(sc[kb][8 * s] * inv, sc[kb][8 * s + 1] * inv); pw.y = cvtpk(sc[kb][8 * s + 2] * inv, sc[kb][8 * s + 3] * inv);
                    pw.z = cvtpk(sc[kb][8 * s + 4] * inv, sc[kb][8 * s + 5] * inv); pw.w = cvtpk(sc[kb][8 * s + 6] * inv, sc[kb][8 * s + 7] * inv);
                    const bf16x8 pa = __builtin_bit_cast(bf16x8, pw);
                    const int key0 = 32 * (qb + kb) + 16 * s + 4 * h + q, qh = (q >> 1) & 1;
                    LAS unsigned char* vb = lds + VIMG + (kvh * 256 + key0) * 128 + (2 * i16 + (p >> 1)) * 16 + (p & 1) * 8;
                    const s16x4 l0 = vtr(vb + (0 ^ qh) * 64), h0 = vtr(vb + 8 * 128 + (0 ^ qh) * 64), l1 = vtr(vb + (1 ^ qh) * 64), h1 = vtr(vb + 8 * 128 + (1 ^ qh) * 64);
                    o0 = __builtin_amdgcn_mfma_f32_32x32x16_bf16(pa, __builtin_shufflevector(l0, h0, 0, 1, 2, 3, 4, 5, 6, 7), o0, 0, 0, 0);
                    o1 = __builtin_amdgcn_mfma_f32_32x32x16_bf16(pa, __builtin_shufflevector(l1, h1, 0, 1, 2, 3, 4, 5, 6, 7), o1, 0, 0, 0);
                }
#pragma unroll
            for (int db = 0; db < 2; ++db) {
#pragma unroll
                for (int r = 0; r < 16; ++r) *(LAS unsigned short*)(ost + crow(r, h) * 64 + r32 * 2) = (unsigned short)(cvtpk(db ? o1[r] : o0[r], 0.f) & 0xffffu);
                const int row = lane >> 1, hf = lane & 1;
                const v4u x0 = *(const LAS v4u*)(ost + row * 64 + hf * 32), x1 = *(const LAS v4u*)(ost + row * 64 + hf * 32 + 16);
                if (32 * qb + row < nq) { bf16* dp = out + (size_t)(32 * qb + row) * D + hq * 64 + 32 * db + hf * 16; *(GAS v4u*)dp = x0; *(GAS v4u*)(dp + 8) = x1; }
            }
        }
    }
    VM_WAIT();
    __syncthreads();
    {
        const f32x4 g0 = *(const GAS f32x4*)(F.goa + 8 * lane), g1 = *(const GAS f32x4*)(F.goa + 8 * lane + 4);
        for (int a = w; a < nq; a += NWAVES) {
            gu64* rp = (gu64*)(out + (size_t)a * D + 8 * lane);
            const unsigned long long w0 = __hip_atomic_load(rp, RLX_AGENT), w1 = __hip_atomic_load(rp + 1, RLX_AGENT);
            const unsigned x0 = (unsigned)w0, x1 = (unsigned)(w0 >> 32), x2 = (unsigned)w1, x3 = (unsigned)(w1 >> 32);
            float v[8] = {bflo(x0), bfhi(x0), bflo(x1), bfhi(x1), bflo(x2), bfhi(x2), bflo(x3), bfhi(x3)};
            float qq = 0.f;
#pragma unroll
            for (int k = 0; k < 8; ++k) qq += v[k] * v[k];
            const float r = rsqrtf(wave_sum(qq) * (1.f / CW) + EPS);
            v4u o; o.x = cvtpk(v[0] * r * g0.x, v[1] * r * g0.y); o.y = cvtpk(v[2] * r * g0.z, v[3] * r * g0.w); o.z = cvtpk(v[4] * r * g1.x, v[5] * r * g1.y); o.w = cvtpk(v[6] * r * g1.z, v[7] * r * g1.w);
            *(GAS v4u*)(out + (size_t)a * D + 8 * lane) = o; }
    }
    __syncthreads();
}

#ifdef SKIP_A
#define mixer_a(...) do{}while(0)
#endif
#ifdef SKIP_B
#define mixer_b(...) do{}while(0)
#endif
__device__ __forceinline__ void p2_mixers(Frame& F) {
    for (int i = F.vcu; i < 256 + 4 + DB; i += F.G) {
        asm volatile("" ::: "memory");
        const bool doA = i < 260, doB = i < 256 || i >= 260, smpA = i >= 256, smpB = i >= 260;
        const int mA = smpA ? MP + 128 * (i - 256) : 128 * i, bd = i - 260, mB = smpB ? MP + 4 * bd : 128 * i;
        const bool first = !smpB && (i & 63) == 0;
        if (doA) { float* cvo = smpA ? F.cvs + (size_t)(i - 256) * 128 * CW : ((i & 63) == 63 ? F.cvp + (size_t)(i >> 6) * 128 * CW : nullptr);
            mixer_a(F, mA, smpA ? F.WSPS16 : F.WSP16, smpA ? 3 : 127, cvo); }
        asm volatile("" ::: "memory");
        if (doB) { const bf16* kvp = smpB ? F.CKV16 + (size_t)bd * 128 * 256 : (first ? nullptr : F.KV + (size_t)(mB - 128) * 256);
            mixer_b(F, kvp, F.KV + (size_t)mB * 256, smpB ? 4 : 128, F.Q + (size_t)mB * CW, smpB ? 4 : 128, first, F.MG + (size_t)mB * D + CW); }
    }
}

__device__ __forceinline__ void p3b_rows(Frame& F) {
    const int gw = F.vcu * NWAVES + F.wave, NGW = F.G * NWAVES, lane = F.lane;
    for (int m = gw; m < M; m += NGW) {
        const GAS f32x4* xr = (const GAS f32x4*)(m < MP ? F.xp + (size_t)m * D : F.xs + (size_t)(m - MP) * D) + lane;
        const GAS f32x4* orow = (const GAS f32x4*)(F.OF + (size_t)m * D) + lane;
        const GAS f32x4* g1 = (const GAS f32x4*)F.gpm + lane; const GAS f32x4* g2 = (const GAS f32x4*)F.gpf + lane;
        f32x4 o[4], x1[4]; float s = 0.f;
#pragma unroll
        for (int j = 0; j < 4; ++j) { o[j] = orow[64 * j]; s += (o[j].x * o[j].x + o[j].y * o[j].y) + (o[j].z * o[j].z + o[j].w * o[j].w); }
        const float r = rsqrtf(wave_sum(s) * (1.f / D) + EPS); float s2 = 0.f;
        GAS f32x4* yr = (GAS f32x4*)(F.y + (size_t)m * D) + lane;
#pragma unroll
        for (int j = 0; j < 4; ++j) { const f32x4 xx = xr[64 * j], gg = g1[64 * j]; x1[j] = xx + o[j] * r * gg; yr[64 * j] = x1[j];
            s2 += (x1[j].x * x1[j].x + x1[j].y * x1[j].y) + (x1[j].z * x1[j].z + x1[j].w * x1[j].w); }
        const float r2 = rsqrtf(wave_sum(s2) * (1.f / D) + EPS);
        GAS unsigned long long* o8 = (GAS unsigned long long*)(F.XN + (size_t)m * D) + lane;
#pragma unroll
        for (int j = 0; j < 4; ++j) { const f32x4 gg = g2[64 * j];
            o8[64 * j] = (unsigned long long)cvtpk(x1[j].x * r2 * gg.x, x1[j].y * r2 * gg.y) | ((unsigned long long)cvtpk(x1[j].z * r2 * gg.z, x1[j].w * r2 * gg.w) << 32); }
    }
}
__device__ __forceinline__ void p5b_rows(Frame& F) {
    const int gw = F.vcu * NWAVES + F.wave, NGW = F.G * NWAVES, lane = F.lane;
    for (int m = gw; m < M; m += NGW) {
        const GAS f32x4* fr = (const GAS f32x4*)(F.OF + (size_t)m * D) + lane; const GAS f32x4* g = (const GAS f32x4*)F.gpo + lane;
        GAS f32x4* yr = (GAS f32x4*)(F.y + (size_t)m * D) + lane;
        f32x4 f[4]; float s = 0.f;
#pragma unroll
        for (int j = 0; j < 4; ++j) { f[j] = fr[64 * j]; s += (f[j].x * f[j].x + f[j].y * f[j].y) + (f[j].z * f[j].z + f[j].w * f[j].w); }
        const float r = rsqrtf(wave_sum(s) * (1.f / D) + EPS);
#pragma unroll
        for (int j = 0; j < 4; ++j) { const f32x4 gg = g[64 * j]; yr[64 * j] = yr[64 * j] + f[j] * r * gg; }
    }
}

constexpr int N_PHASES = 8;
struct Args { const float* in[19]; float* out; unsigned char* ws; int ph_lo, ph_hi, use_bar, pad; };
__global__ void __launch_bounds__(NWAVES * 64, 2) mega_fwd(Args args) {
    extern __shared__ __attribute__((aligned(16))) unsigned char lds_raw[];
    Frame F;
    F.lds = (LAS unsigned char*)lds_raw;
    F.tid = threadIdx.x; F.lane = F.tid & 63; F.wave = __builtin_amdgcn_readfirstlane(F.tid >> 6);
    F.G = gridDim.x; { const int bx = blockIdx.x; F.vcu = (F.G % 8 == 0) ? (bx % 8) * (F.G / 8) + bx / 8 : bx; }
    const float* const* in = args.in;
    F.xp = in[0]; F.xs = in[1]; F.ck = in[2]; F.cv = in[3]; F.w_in = in[4]; F.g_pre = in[5]; F.lng = in[6]; F.lnb = in[7]; F.wsp = in[8]; F.bsp = in[9];
    F.sinks = in[10]; F.goc = in[11]; F.goa = in[12]; F.w_o = in[13]; F.gpm = in[14]; F.gpf = in[15]; F.w_up = in[16]; F.w_dn = in[17]; F.gpo = in[18];
    float* out = args.out;
    F.y = out; F.wkp = out + (size_t)M * D; F.wvp = F.wkp + 65536; F.cvp = F.wvp + 65536; F.wks = F.cvp + 262144; F.wvs = F.wks + 2097152; F.cvs = F.wvs + 2097152;
    unsigned char* ws = args.ws;
    F.Wt_in = (bf16*)(ws + WS_WIN); F.Wt_o = (bf16*)(ws + WS_WO); F.Wt_up = (bf16*)(ws + WS_WUP); F.Wt_dn = (bf16*)(ws + WS_WDN);
    F.WSP16 = (bf16*)(ws + WS_WSP); F.WSPS16 = F.WSP16 + 8 * 128 * 128; F.CKV16 = (bf16*)(ws + WS_CKV);
    F.XN = (bf16*)(ws + WS_XN); F.U = (bf16*)(ws + WS_U); F.GV = (bf16*)(ws + WS_GV); F.Q = (bf16*)(ws + WS_Q); F.KV = (bf16*)(ws + WS_KV); F.MG = (bf16*)(ws + WS_MG);
    F.H = (bf16*)(ws + WS_H); F.OF = (float*)(ws + WS_OF);
    volatile LAS unsigned* MISC = (volatile LAS unsigned*)(F.lds + MISC_OFF);
    for (int u = F.tid; u < (LDS_BYTES - MISC_OFF) / 4; u += NWAVES * 64) ((LAS unsigned*)(F.lds + MISC_OFF))[u] = 0u;
    __syncthreads();
    XcdBarrier bar; bar.bar = (unsigned*)(ws + WS_CTL) + CW_BAR; bar.x = 0; bar.st = nullptr;
    if (args.use_bar) bar = xcd_barrier_post((unsigned*)(ws + WS_CTL) + CW_BAR, MISC + 8);
    const int lo = args.ph_lo, hi = args.ph_hi;
#ifndef PH_MASK
#define PH_MASK 0xff
#endif
#define IN(k) (lo <= (k) && (k) < hi && ((PH_MASK >> (k)) & 1))
#define SEAM(k) do { if (IN(k) && IN((k) + 1)) xcd_barrier(bar); } while (0)
    if (IN(0)) { p0_prologue(F); } SEAM(0);
    if (IN(1)) { pg8::Gemm g{F.XN, F.Wt_in, M, INW, D}; pg8::StaticOrder S; S.init(M, INW, F.G, (int)blockIdx.x);
        pg8::EpiIn E{F.U, F.KV, (size_t)(WS_GV - WS_U) / 2, F.wkp, F.wvp, F.wks, F.wvs};
        static_assert(WS_Q - WS_GV == WS_GV - WS_U, "U | GV | Q equally spaced");
        pg8::gemm_phase<pg8::EpiIn, pg8::StaticOrder, PG8_ALIGN, PG8_SP2>(F.lds, g, S, E); } SEAM(1);
    if (IN(2)) { p2_mixers(F); } SEAM(2);
    if (IN(3)) { pg8::Gemm g{F.MG, F.Wt_o, M, D, D}; pg8::StaticOrder S; S.init(M, D, F.G, (int)blockIdx.x);
        pg8::EpiF32 E{F.OF, D};
        pg8::gemm_phase<pg8::EpiF32, pg8::StaticOrder, PG8_ALIGN, PG8_SP2>(F.lds, g, S, E); } SEAM(3);
    if (IN(4)) { p3b_rows(F); } SEAM(4);
    if (IN(5)) { pg8::Gemm g{F.XN, F.Wt_up, M, FF, D}; pg8::StaticOrder S; S.init(M, FF, F.G, (int)blockIdx.x);
        pg8::EpiRelu2 E{F.H, FF};
        pg8::gemm_phase<pg8::EpiRelu2, pg8::StaticOrder, PG8_ALIGN, PG8_SP2>(F.lds, g, S, E); } SEAM(5);
    if (IN(6)) { pg8::Gemm g{F.H, F.Wt_dn, M, D, FF}; pg8::StaticOrder S; S.init(M, D, F.G, (int)blockIdx.x);
        pg8::EpiF32 E{F.OF, D};
        pg8::gemm_phase<pg8::EpiF32, pg8::StaticOrder, PG8_ALIGN, PG8_SP2>(F.lds, g, S, E); } SEAM(6);
    if (IN(7)) { p5b_rows(F); }
#undef IN
#undef SEAM
}

#ifndef MK_N_LAUNCHES
#define MK_N_LAUNCHES 1
#endif
extern "C" void kernel_launch(void* const* d_in, const int* in_sizes, int n_in, void* d_out, int out_size, void* d_ws, size_t ws_size, hipStream_t stream) {
    static int grid = 0;
    if (grid == 0) {
        if (n_in != 19 || in_sizes[0] != MP * D || ws_size < WS_END) { fprintf(stderr, "kernel_launch: unexpected shapes (n_in %d, in0 %d, ws %zu); nothing launched\n", n_in, n_in > 0 ? in_sizes[0] : -1, ws_size); grid = -1; return; }
        int dev = 0, cus = 0, per_cu = 0;
        if (hipGetDevice(&dev) != hipSuccess || hipDeviceGetAttribute(&cus, hipDeviceAttributeMultiprocessorCount, dev) != hipSuccess) { grid = -1; return; }
        if (hipFuncSetAttribute((const void*)mega_fwd, hipFuncAttributeMaxDynamicSharedMemorySize, LDS_BYTES) != hipSuccess) { fprintf(stderr, "kernel_launch: hipFuncSetAttribute failed\n"); grid = -1; return; }
        if (hipOccupancyMaxActiveBlocksPerMultiprocessor(&per_cu, (const void*)mega_fwd, NWAVES * 64, LDS_BYTES) != hipSuccess || per_cu < 1) { fprintf(stderr, "kernel_launch: occupancy query says %d blocks per CU\n", per_cu); }
        (void)hipGetLastError();
        grid = cus;
    }
    if (grid < 0) return;
    (void)hipMemsetAsync((char*)d_ws + WS_CTL, 0, CTL_ZERO_BYTES, stream);
    Args a{};
    for (int i = 0; i < 19; ++i) a.in[i] = (const float*)d_in[i];
    a.out = (float*)d_out; a.ws = (unsigned char*)d_ws;
    if (MK_N_LAUNCHES == 1) { a.ph_lo = 0; a.ph_hi = N_PHASES; a.use_bar = 1; hipLaunchKernelGGL(mega_fwd, dim3(grid), dim3(NWAVES * 64), LDS_BYTES, stream, a); }
    else for (int p = 0; p < N_PHASES; ++p) { a.ph_lo = p; a.ph_hi = p + 1; a.use_bar = 0; hipLaunchKernelGGL(mega_fwd, dim3(grid), dim3(NWAVES * 64), LDS_BYTES, stream, a); }
}
```
